# Optimizing an MI355X kernel written in HIP

```python
import jax, jax.numpy as jnp
from jax import lax
import numpy as np

D_MODEL = 1024
BATCH = 8
SEQ = 2048
DEPTH = 1
DEC_BATCH = 128
DEC_SEQ = 4
PAST_LEN = 16384
PAGE_SIZE = 128

D_A = D_MODEL
D_P = D_MODEL
POOL_WINDOWS = (2, 4, 8, 16)
N_POOL_GROUPS = len(POOL_WINDOWS)
POOL_GROUP = D_P // N_POOL_GROUPS
POOL_MAX = max(POOL_WINDOWS)
CONV_W = 3
D_FF = 2816
PLE_DIM = 256
EPS = 1e-6
D_IN_ALL = 3 * D_A + D_P + 2 * D_MODEL

kernel_name = "hybrid_shortconv_pool_convffn_step"


def rmsnorm(x, g):
    xf = x.astype(jnp.float32)
    ms = jnp.mean(xf * xf, axis=-1, keepdims=True)
    return (xf * lax.rsqrt(ms + EPS)).astype(x.dtype) * g


def causal_dwconv(v, buf, w):
    L = v.shape[1]
    ext = jnp.concatenate([buf.astype(v.dtype), v], axis=1)
    y = ext[:, 0:L] * w[0]
    for k in range(1, CONV_W):
        y = y + ext[:, k:k + L] * w[k]
    return y, ext[:, L:]


def multiscale_pool(u, buf, start_pos, w_grp, scale):
    Bsz, L, C = u.shape
    ext = jnp.concatenate([buf.astype(u.dtype), u], axis=1)
    cs = jnp.cumsum(ext.astype(jnp.float32), axis=1)
    cs = jnp.concatenate([jnp.zeros((Bsz, 1, C), jnp.float32), cs], axis=1)
    csg = cs.reshape(Bsz, POOL_MAX + L, N_POOL_GROUPS, POOL_GROUP)
    end = csg[:, POOL_MAX:]
    pos = start_pos + jnp.arange(L)
    outs = []
    for gi, w in enumerate(POOL_WINDOWS):
        s = csg[:, POOL_MAX - w:POOL_MAX - w + L, gi]
        cnt = jnp.minimum(pos + 1, w).astype(jnp.float32)
        outs.append((end[:, :, gi] - s) / cnt[None, :, None])
    pooled = jnp.stack(outs, axis=2)
    ug = u.reshape(Bsz, L, N_POOL_GROUPS, POOL_GROUP).astype(jnp.float32)
    d = (pooled - ug).astype(u.dtype)
    y = jnp.einsum('blgc,gcd->blgd', d, w_grp).reshape(Bsz, L, C) * scale
    return y, ext[:, L:]


def hybrid_layer(x, p, conv_buf, pool_buf, ffn_buf, start_pos,
                 g_pre_mix, w_in, conv_a_w, w_a_out, pool_w, pool_scale, w_o, g_post_mix,
                 g_pre_ffn, w_up, ffn_conv_w, w_down, g_post_ffn, w_ple_proj, w_ple_gate):
    xn = rmsnorm(x, g_pre_mix)
    proj = xn @ w_in
    splits = np.cumsum([D_A, D_A, D_A, D_P, D_MODEL])
    b_a, c_a, h_a, u_p, gate_a, gate_p = jnp.split(proj, splits, axis=-1)
    conv_out, new_conv = causal_dwconv(c_a * h_a, conv_buf, conv_a_w)
    y_a = (b_a * conv_out) @ w_a_out
    y_p, new_pool = multiscale_pool(u_p, pool_buf, start_pos, pool_w, pool_scale)
    merged = jax.nn.sigmoid(gate_a) * y_a + jax.nn.sigmoid(gate_p) * y_p
    x = x + rmsnorm(merged @ w_o, g_post_mix)
    hn = rmsnorm(x, g_pre_ffn)
    up = hn @ w_up
    a, g = jnp.split(up, [D_FF], axis=-1)
    a_c, new_ffn = causal_dwconv(a, ffn_buf, ffn_conv_w)
    f = (jax.nn.gelu(a_c, approximate=True) * g) @ w_down
    x = x + rmsnorm(f, g_post_ffn)
    x = x + jax.nn.sigmoid(x @ w_ple_gate) * (p @ w_ple_proj)
    return x, new_conv, new_pool, new_ffn


def setup_inputs(seed: int = 0) -> dict:
    key = jax.random.key(seed)
    ks = jax.random.split(key, 24)
    f32 = jnp.float32

    def nrm(k, shape, scale):
        return jax.random.normal(k, shape, f32) * scale

    def gain(k, shape):
        return 1.0 + 0.05 * jax.random.normal(k, shape, f32)

    return {
        "x_prompt": nrm(ks[0], (BATCH, SEQ, D_MODEL), 1.0),
        "x_sample": nrm(ks[1], (DEC_BATCH, DEC_SEQ, D_MODEL), 1.0),
        "p_prompt": nrm(ks[2], (DEPTH, BATCH, SEQ, PLE_DIM), 1.0),
        "p_sample": nrm(ks[3], (DEPTH, DEC_BATCH, DEC_SEQ, PLE_DIM), 1.0),
        "state_conv_a": nrm(ks[4], (DEPTH, DEC_BATCH, CONV_W - 1, D_A), 1.0),
        "state_pool": nrm(ks[5], (DEPTH, DEC_BATCH, POOL_MAX - 1, D_P), 1.0),
        "state_ffn_conv": nrm(ks[6], (DEPTH, DEC_BATCH, CONV_W - 1, D_FF), 1.0),
        "g_pre_mix": gain(ks[7], (DEPTH, D_MODEL)),
        "w_in": nrm(ks[8], (DEPTH, D_MODEL, D_IN_ALL), D_MODEL ** -0.5),
        "conv_a_w": nrm(ks[9], (DEPTH, CONV_W, D_A), CONV_W ** -0.5),
        "w_a_out": nrm(ks[10], (DEPTH, D_A, D_MODEL), D_A ** -0.5),
        "pool_w": nrm(ks[11], (DEPTH, N_POOL_GROUPS, POOL_GROUP, POOL_GROUP), POOL_GROUP ** -0.5),
        "pool_scale": gain(ks[12], (DEPTH, D_P)),
        "w_o": nrm(ks[13], (DEPTH, D_MODEL, D_MODEL), D_MODEL ** -0.5),
        "g_post_mix": gain(ks[14], (DEPTH, D_MODEL)),
        "g_pre_ffn": gain(ks[15], (DEPTH, D_MODEL)),
        "w_up": nrm(ks[16], (DEPTH, D_MODEL, 2 * D_FF), D_MODEL ** -0.5),
        "ffn_conv_w": nrm(ks[17], (DEPTH, CONV_W, D_FF), CONV_W ** -0.5),
        "w_down": nrm(ks[18], (DEPTH, D_FF, D_MODEL), D_FF ** -0.5),
        "g_post_ffn": gain(ks[19], (DEPTH, D_MODEL)),
        "w_ple_proj": nrm(ks[20], (DEPTH, PLE_DIM, D_MODEL), PLE_DIM ** -0.5),
        "w_ple_gate": nrm(ks[21], (DEPTH, D_MODEL, D_MODEL), D_MODEL ** -0.5),
    }


def reference(x_prompt, x_sample, p_prompt, p_sample, state_conv_a, state_pool, state_ffn_conv,
              g_pre_mix, w_in, conv_a_w, w_a_out, pool_w, pool_scale, w_o, g_post_mix,
              g_pre_ffn, w_up, ffn_conv_w, w_down, g_post_ffn, w_ple_proj, w_ple_gate):
    xp, xs = x_prompt, x_sample
    conv_p, pool_p, ffn_p = [], [], []
    conv_s, pool_s, ffn_s = [], [], []
    for i in range(DEPTH):
        w = (g_pre_mix[i], w_in[i], conv_a_w[i], w_a_out[i], pool_w[i], pool_scale[i], w_o[i],
             g_post_mix[i], g_pre_ffn[i], w_up[i], ffn_conv_w[i], w_down[i], g_post_ffn[i],
             w_ple_proj[i], w_ple_gate[i])
        zc = jnp.zeros((BATCH, CONV_W - 1, D_A), xp.dtype)
        zp = jnp.zeros((BATCH, POOL_MAX - 1, D_P), xp.dtype)
        zf = jnp.zeros((BATCH, CONV_W - 1, D_FF), xp.dtype)
        xp, c1, p1, f1 = hybrid_layer(xp, p_prompt[i], zc, zp, zf, 0, *w)
        xs, c2, p2, f2 = hybrid_layer(xs, p_sample[i], state_conv_a[i], state_pool[i],
                                      state_ffn_conv[i], PAST_LEN, *w)
        conv_p.append(c1); pool_p.append(p1); ffn_p.append(f1)
        conv_s.append(c2); pool_s.append(p2); ffn_s.append(f2)
    new_conv_a_prompt = jnp.stack(conv_p, axis=0)
    new_pool_prompt = jnp.stack(pool_p, axis=0)
    new_ffn_prompt = jnp.stack(ffn_p, axis=0)
    new_conv_a_sample = jnp.stack(conv_s, axis=0)
    new_pool_sample = jnp.stack(pool_s, axis=0)
    new_ffn_sample = jnp.stack(ffn_s, axis=0)
    return (xp, xs, new_conv_a_prompt, new_pool_prompt, new_ffn_prompt,
            new_conv_a_sample, new_pool_sample, new_ffn_sample)
```

```cpp
#include <hip/hip_runtime.h>
#include <cstdio>
#include <cstdint>

#define GAS __attribute__((address_space(1)))
#define LAS __attribute__((address_space(3)))
typedef unsigned short bf16;
typedef short bf16x8 __attribute__((ext_vector_type(8)));
typedef float f32x4 __attribute__((ext_vector_type(4)));
typedef float f32x16 __attribute__((ext_vector_type(16)));
typedef unsigned v4u __attribute__((ext_vector_type(4)));
typedef unsigned v2u __attribute__((ext_vector_type(2)));

constexpr int DM = 1024, NB = 8, SEQ = 2048, DB = 128, DSEQ = 4, PAST = 16384;
constexpr int DFF = 2816, PLE = 256, DIN = 6144;
constexpr float EPS = 1e-6f;
constexpr int MP = NB * SEQ;
constexpr int MS = DB * DSEQ;
constexpr int NWAVES = 8, NTHR = 512;

constexpr size_t O_YP = 0;
constexpr size_t O_YS = O_YP + (size_t)MP * DM;
constexpr size_t O_CONV_P = O_YS + (size_t)MS * DM;
constexpr size_t O_POOL_P = O_CONV_P + (size_t)NB * 2 * DM;
constexpr size_t O_FFN_P = O_POOL_P + (size_t)NB * 15 * DM;
constexpr size_t O_CONV_S = O_FFN_P + (size_t)NB * 2 * DFF;
constexpr size_t O_POOL_S = O_CONV_S + (size_t)DB * 2 * DM;
constexpr size_t O_FFN_S = O_POOL_S + (size_t)DB * 15 * DM;
constexpr size_t O_END = O_FFN_S + (size_t)DB * 2 * DFF;

constexpr size_t MiB = 1u << 20;
constexpr size_t WS_CTL = 0, CTL_ZERO_BYTES = 64 * 1024;
constexpr size_t WS_WIN = 1 * MiB;
constexpr size_t WS_WA = 13 * MiB;
constexpr size_t WS_WO = 15 * MiB;
constexpr size_t WS_WG = 17 * MiB;
constexpr size_t WS_WUP = 19 * MiB;
constexpr size_t WS_WDN = 30 * MiB;
constexpr size_t WS_WP = 36 * MiB;
constexpr size_t WS_WPLE = 37 * MiB;
constexpr int RMAX = 4096;
constexpr size_t WS_XN = 38 * MiB;
constexpr size_t WS_A2 = 46 * MiB;
constexpr size_t WS_D = 54 * MiB;
constexpr size_t WS_MG = 62 * MiB;
constexpr size_t WS_YA = 70 * MiB;
constexpr size_t WS_YP = 86 * MiB;
constexpr size_t WS_X1 = 102 * MiB;
constexpr size_t WS_HM = 118 * MiB;
constexpr size_t WS_PB = 140 * MiB;
constexpr size_t WS_PROJ = 142 * MiB;
constexpr size_t WS_END = 238 * MiB;

constexpr int LDS_BYTES = 147456;
constexpr int MISC_OFF = 131072;

#define RLX_AGENT __ATOMIC_RELAXED, __HIP_MEMORY_SCOPE_AGENT
#define LDS_WAIT() asm volatile("s_waitcnt lgkmcnt(0)" ::: "memory")

__device__ __forceinline__ unsigned f2bf(float f) { unsigned u = __builtin_bit_cast(unsigned, f); return (u + 0x7fffu + ((u >> 16) & 1u)) >> 16; }
__device__ __forceinline__ unsigned pk2(float lo, float hi) { return f2bf(lo) | (f2bf(hi) << 16); }
__device__ __forceinline__ float bf2f(unsigned short b) { return __builtin_bit_cast(float, (unsigned)b << 16); }
__device__ __forceinline__ float sigmoidf_(float x) { return 1.0f / (1.0f + __expf(-x)); }
__device__ __forceinline__ float gelu_tanh(float x) {
    const float u = 0.7978845608028654f * (x + 0.044715f * x * x * x);
    return x / (1.0f + __expf(-2.0f * u));
}

#define XB_TMO      128
#define XB_XCNT(j)  (256  + 64 * (j))
#define XB_XSUB(j)  (1280 + 64 * (j))
#define XB_XGEN(j)  (2304 + 64 * (j))
#define XB_TOP      3328
#define XB_TOPGEN   3392
#define XCD_BAR_WORDS 3456
#define XB_SPIN_CAP (1u << 18)
__device__ __forceinline__ unsigned xb_ld(unsigned* p)              { return __hip_atomic_load(p, __ATOMIC_RELAXED, __HIP_MEMORY_SCOPE_AGENT); }
__device__ __forceinline__ unsigned xb_add(unsigned* p, unsigned v) { return __hip_atomic_fetch_add(p, v, __ATOMIC_RELAXED, __HIP_MEMORY_SCOPE_AGENT); }
__device__ __forceinline__ unsigned xb_xcc_id() { return (unsigned)__builtin_amdgcn_s_getreg((3 << 11) | 20) & 0xFu; }
#define XB_SPIN(cond, bar) do { unsigned _sp = 0; while (cond) { __builtin_amdgcn_s_sleep(1); \
    if ((++_sp & 255u) == 0u) { if (xb_ld(&(bar)[XB_TMO])) break; if (_sp > XB_SPIN_CAP) { atomicAdd(&(bar)[XB_TMO], 1u); break; } } } } while (0)
struct XcdBarrier { unsigned* bar; unsigned x; volatile LAS unsigned* st; };
__device__ __forceinline__ XcdBarrier xcd_barrier_post(unsigned* bar, volatile LAS unsigned* st) {
    XcdBarrier b; b.bar = bar; b.x = xb_xcc_id(); b.st = st;
    if (threadIdx.x == 0) (void)xb_add(&bar[XB_XCNT(b.x)], 1u);
    return b;
}
__device__ __forceinline__ void xcd_barrier_complete(unsigned* bar, unsigned x, unsigned& nloc, unsigned& nx) {
    const unsigned G = gridDim.x * gridDim.y * gridDim.z;
    unsigned sum, cnt, mine, sp = 0u;
    for (;;) {
        sum = 0u; cnt = 0u; mine = 0u;
#pragma unroll
        for (unsigned j = 0; j < 16; ++j) { const unsigned c = xb_ld(&bar[XB_XCNT(j)]); sum += c; cnt += (c > 0u) ? 1u : 0u; mine = (j == x) ? c : mine; }
        if (sum == G) break;
        __builtin_amdgcn_s_sleep(1);
        if ((++sp & 255u) == 0u) { if (xb_ld(&bar[XB_TMO])) break; if (sp > XB_SPIN_CAP) { atomicAdd(&bar[XB_TMO], 1u); break; } }
    }
    nloc = mine > 0u ? mine : 1u; nx = cnt > 0u ? cnt : 1u;
}
__device__ __forceinline__ void xcd_barrier(const XcdBarrier& b) {
    asm volatile("s_waitcnt vmcnt(0)" ::: "memory");
    __syncthreads();
    if (threadIdx.x == 0) {
        unsigned* bar = b.bar;
        __builtin_amdgcn_s_waitcnt(0);
        unsigned nloc = b.st[0], nx = b.st[1];
        if (nloc == 0u) { xcd_barrier_complete(bar, b.x, nloc, nx); b.st[0] = nloc; b.st[1] = nx; }
        const unsigned old = xb_add(&bar[XB_XSUB(b.x)], 1u);
        const unsigned gen = old / nloc;
        if (old + 1u == (gen + 1u) * nloc) {
            __builtin_amdgcn_fence(__ATOMIC_RELEASE, "agent");
            asm volatile("s_waitcnt vmcnt(0)" ::: "memory");
            const unsigned og = xb_add(&bar[XB_TOP], 1u);
            const unsigned tg = og / nx;
            if (og + 1u == (tg + 1u) * nx) xb_add(&bar[XB_TOPGEN], 1u);
            else XB_SPIN(xb_ld(&bar[XB_TOPGEN]) == tg, bar);
            __builtin_amdgcn_fence(__ATOMIC_ACQUIRE, "agent");
            xb_add(&bar[XB_XGEN(b.x)], 1u);
            asm volatile("s_waitcnt vmcnt(0)" ::: "memory");
        } else {
            XB_SPIN(xb_ld(&bar[XB_XGEN(b.x)]) == gen, bar);
            __builtin_amdgcn_fence(__ATOMIC_ACQUIRE, "agent");
            asm volatile("s_waitcnt vmcnt(0)" ::: "memory");
        }
    }
    __syncthreads();
}

struct Args {
    const float* in[22];
    float* out;
    unsigned char* ws;
};

__device__ __forceinline__ float wave_sum(float v) {
#pragma unroll
    for (int o = 1; o < 64; o <<= 1) v += __shfl_xor(v, o);
    return v;
}

__device__ __forceinline__ void p0_transpose_item(const float* W, int K, int N, bf16* WT, int row_off, LAS float* scr, int item, int lane) {
    const int nblk = N / 32, kb = item / nblk, nb = item % nblk, k0 = 64 * kb, n0 = 32 * nb;
#pragma unroll 8
    for (int i = 0; i < 32; ++i) { const int kk = 2 * i + (lane >> 5); scr[kk * 33 + (lane & 31)] = W[(size_t)(k0 + kk) * N + n0 + (lane & 31)]; }
    LDS_WAIT(); asm volatile("" ::: "memory");
    const int c = lane & 7;
#pragma unroll
    for (int j = 0; j < 4; ++j) { const int n = (lane >> 3) + 8 * j; const LAS float* s = scr + (8 * c) * 33 + n;
        v4u o; o.x = pk2(s[0 * 33], s[1 * 33]); o.y = pk2(s[2 * 33], s[3 * 33]); o.z = pk2(s[4 * 33], s[5 * 33]); o.w = pk2(s[6 * 33], s[7 * 33]);
        *(GAS v4u*)(WT + (size_t)(row_off + n0 + n) * K + k0 + 8 * c) = o; }
    LDS_WAIT(); asm volatile("" ::: "memory");
}

template <class Epi>
__device__ __forceinline__ void sgemm(const bf16* A, int lda, const bf16* Bt, int ldb, int M, int N, int K, int gw, int NGW, int lane, const Epi& epi) {
    const int tn_n = N / 64, ntiles = (M / 64) * tn_n;
    const int r = lane & 31, h = lane >> 5;
    for (int tile = gw; tile < ntiles; tile += NGW) {
        const int tm = tile / tn_n, tn = tile % tn_n;
        const bf16* a0 = A + (size_t)(tm * 64 + r) * lda + 8 * h;
        const bf16* a1 = a0 + (size_t)32 * lda;
        const bf16* b0 = Bt + (size_t)(tn * 64 + r) * ldb + 8 * h;
        const bf16* b1 = b0 + (size_t)32 * ldb;
        f32x16 c00, c01, c10, c11;
#pragma unroll
        for (int i = 0; i < 16; ++i) { c00[i] = 0.f; c01[i] = 0.f; c10[i] = 0.f; c11[i] = 0.f; }
#pragma unroll 4
        for (int k = 0; k < K; k += 16) {
            const bf16x8 fa0 = *(const bf16x8*)(a0 + k), fa1 = *(const bf16x8*)(a1 + k);
            const bf16x8 fb0 = *(const bf16x8*)(b0 + k), fb1 = *(const bf16x8*)(b1 + k);
            c00 = __builtin_amdgcn_mfma_f32_32x32x16_bf16(fa0, fb0, c00, 0, 0, 0);
            c01 = __builtin_amdgcn_mfma_f32_32x32x16_bf16(fa0, fb1, c01, 0, 0, 0);
            c10 = __builtin_amdgcn_mfma_f32_32x32x16_bf16(fa1, fb0, c10, 0, 0, 0);
            c11 = __builtin_amdgcn_mfma_f32_32x32x16_bf16(fa1, fb1, c11, 0, 0, 0);
        }
#pragma unroll
        for (int g = 0; g < 16; ++g) {
            const int i = (g & 3) + 8 * (g >> 2) + 4 * h;
            epi(tm * 64 + i, tn * 64 + r, c00[g]);
            epi(tm * 64 + i, tn * 64 + 32 + r, c01[g]);
            epi(tm * 64 + 32 + i, tn * 64 + r, c10[g]);
            epi(tm * 64 + 32 + i, tn * 64 + 32 + r, c11[g]);
        }
    }
}
struct EpiStoreF32 { float* C; int ldc; int coff;
    __device__ __forceinline__ void operator()(int row, int col, float v) const { C[(size_t)row * ldc + coff + col] = v; } };

struct Group {
    const float* x; const float* p; float* y; int nseq, L, pos0, R;
    const float* st_conv; const float* st_pool; const float* st_ffn;
    float* new_conv; float* new_pool; float* new_ffn;
};

__global__ void __launch_bounds__(NTHR, 2) fwd_kernel(Args args) {
    extern __shared__ __attribute__((aligned(16))) unsigned char lds[];
    LAS unsigned char* L = (LAS unsigned char*)lds;
    volatile LAS unsigned* MISC = (volatile LAS unsigned*)(L + MISC_OFF);
    const int tid = threadIdx.x, lane = tid & 63, wave = __builtin_amdgcn_readfirstlane(tid >> 6);
    const int G = gridDim.x;
    const int vcu = (G % 8 == 0) ? (blockIdx.x % 8) * (G / 8) + blockIdx.x / 8 : blockIdx.x;
    const int gw = vcu * NWAVES + wave, NGW = G * NWAVES;
    unsigned char* ws = args.ws;
    unsigned* ctl = (unsigned*)(ws + WS_CTL);
    for (int u = tid; u < 64; u += NTHR) MISC[u] = 0u;
    __syncthreads();
    XcdBarrier bar = xcd_barrier_post(ctl + 1024, MISC + 8);

    const float* g_pre_mix = args.in[7]; const float* w_in = args.in[8]; const float* conv_a_w = args.in[9]; const float* w_a_out = args.in[10];
    const float* pool_w = args.in[11]; const float* pool_scale = args.in[12]; const float* w_o = args.in[13]; const float* g_post_mix = args.in[14];
    const float* g_pre_ffn = args.in[15]; const float* w_up = args.in[16]; const float* ffn_conv_w = args.in[17]; const float* w_down = args.in[18];
    const float* g_post_ffn = args.in[19]; const float* w_ple_proj = args.in[20]; const float* w_ple_gate = args.in[21];
    bf16* Wt_in = (bf16*)(ws + WS_WIN); bf16* Wt_a = (bf16*)(ws + WS_WA); bf16* Wt_o = (bf16*)(ws + WS_WO); bf16* Wt_g = (bf16*)(ws + WS_WG);
    bf16* Wt_up = (bf16*)(ws + WS_WUP); bf16* Wt_dn = (bf16*)(ws + WS_WDN); bf16* Wt_p = (bf16*)(ws + WS_WP); bf16* Wt_ple = (bf16*)(ws + WS_WPLE);
    bf16* XN = (bf16*)(ws + WS_XN); bf16* A2 = (bf16*)(ws + WS_A2); bf16* Dd = (bf16*)(ws + WS_D); bf16* MG = (bf16*)(ws + WS_MG);
    float* YA = (float*)(ws + WS_YA); float* YP = (float*)(ws + WS_YP); float* X1 = (float*)(ws + WS_X1);
    bf16* HM = (bf16*)(ws + WS_HM); bf16* PB = (bf16*)(ws + WS_PB); float* PROJ = (float*)(ws + WS_PROJ);

    {
        LAS float* scr = (LAS float*)(L + wave * 16384);
        constexpr int I_IN = (DM / 64) * (DIN / 32), I_SQ = (DM / 64) * (DM / 32), I_UP = (DM / 64) * (2 * DFF / 32), I_DN = (DFF / 64) * (DM / 32),
                      I_P = (256 / 64) * (256 / 32), I_PLE = (PLE / 64) * (DM / 32);
        constexpr int NITEMS = I_IN + 3 * I_SQ + I_UP + I_DN + 4 * I_P + I_PLE;
        for (int it = gw; it < NITEMS; it += NGW) {
            int r = it;
            if (r < I_IN) { p0_transpose_item(w_in, DM, DIN, Wt_in, 0, scr, r, lane); continue; } r -= I_IN;
            if (r < I_SQ) { p0_transpose_item(w_a_out, DM, DM, Wt_a, 0, scr, r, lane); continue; } r -= I_SQ;
            if (r < I_SQ) { p0_transpose_item(w_o, DM, DM, Wt_o, 0, scr, r, lane); continue; } r -= I_SQ;
            if (r < I_SQ) { p0_transpose_item(w_ple_gate, DM, DM, Wt_g, 0, scr, r, lane); continue; } r -= I_SQ;
            if (r < I_UP) { p0_transpose_item(w_up, DM, 2 * DFF, Wt_up, 0, scr, r, lane); continue; } r -= I_UP;
            if (r < I_DN) { p0_transpose_item(w_down, DFF, DM, Wt_dn, 0, scr, r, lane); continue; } r -= I_DN;
            if (r < 4 * I_P) { const int g = r / I_P; p0_transpose_item(pool_w + (size_t)g * 256 * 256, 256, 256, Wt_p + (size_t)g * 256 * 256, 0, scr, r % I_P, lane); continue; } r -= 4 * I_P;
            p0_transpose_item(w_ple_proj, PLE, DM, Wt_ple, 0, scr, r, lane);
        }
    }
    xcd_barrier(bar);

    constexpr int NPASS = MP / RMAX + 1;
    for (int pass = 0; pass < NPASS; ++pass) {
        Group g;
        if (pass < MP / RMAX) {
            const int s0 = pass * (RMAX / SEQ);
            g.x = args.in[0] + (size_t)s0 * SEQ * DM; g.p = args.in[2] + (size_t)s0 * SEQ * PLE; g.y = args.out + O_YP + (size_t)s0 * SEQ * DM;
            g.nseq = RMAX / SEQ; g.L = SEQ; g.pos0 = 0; g.R = RMAX; g.st_conv = nullptr; g.st_pool = nullptr; g.st_ffn = nullptr;
            g.new_conv = args.out + O_CONV_P + (size_t)s0 * 2 * DM; g.new_pool = args.out + O_POOL_P + (size_t)s0 * 15 * DM; g.new_ffn = args.out + O_FFN_P + (size_t)s0 * 2 * DFF;
        } else {
            g.x = args.in[1]; g.p = args.in[3]; g.y = args.out + O_YS; g.nseq = DB; g.L = DSEQ; g.pos0 = PAST; g.R = MS;
            g.st_conv = args.in[4]; g.st_pool = args.in[5]; g.st_ffn = args.in[6];
            g.new_conv = args.out + O_CONV_S; g.new_pool = args.out + O_POOL_S; g.new_ffn = args.out + O_FFN_S;
        }
        const int R = g.R, Lq = g.L;

        for (int r = gw; r < R; r += NGW) {
            const f32x4* xr = (const f32x4*)(g.x + (size_t)r * DM) + lane; f32x4 v[4]; float s = 0.f;
#pragma unroll
            for (int j = 0; j < 4; ++j) { v[j] = xr[64 * j]; s += (v[j].x * v[j].x + v[j].y * v[j].y) + (v[j].z * v[j].z + v[j].w * v[j].w); }
            const float rs = rsqrtf(wave_sum(s) * (1.f / DM) + EPS);
            v2u* o8 = (v2u*)(XN + (size_t)r * DM) + lane;
#pragma unroll
            for (int j = 0; j < 4; ++j) { const f32x4 gg = ((const f32x4*)g_pre_mix)[lane + 64 * j]; v2u o; o.x = pk2(v[j].x * rs * gg.x, v[j].y * rs * gg.y); o.y = pk2(v[j].z * rs * gg.z, v[j].w * rs * gg.w); o8[64 * j] = o; }
        }
        xcd_barrier(bar);
        sgemm(XN, DM, Wt_in, DM, R, DIN, DM, gw, NGW, lane, EpiStoreF32{PROJ, DIN, 0});
        xcd_barrier(bar);
        {
            const int CH = Lq < 32 ? Lq : 32, nch = Lq / CH, nitems = g.nseq * nch * 2;
            for (int it = vcu; it < nitems; it += G) {
                const int cb = it & 1, chk = (it >> 1) % nch, b = (it >> 1) / nch, c = cb * 512 + tid, t0 = chk * CH;
                const float w0 = conv_a_w[c], w1 = conv_a_w[DM + c], w2 = conv_a_w[2 * DM + c];
                const float* pr = PROJ + (size_t)b * Lq * DIN;
                auto chv = [&](int t) -> float { if (t >= 0) return pr[(size_t)t * DIN + DM + c] * pr[(size_t)t * DIN + 2 * DM + c]; return g.st_conv ? g.st_conv[((size_t)b * 2 + (2 + t)) * DM + c] : 0.f; };
                auto uv = [&](int t) -> float { if (t >= 0) return pr[(size_t)t * DIN + 3 * DM + c]; return g.st_pool ? g.st_pool[((size_t)b * 15 + (15 + t)) * DM + c] : 0.f; };
                const int w = 2 << (c >> 8);
                float v2 = chv(t0 - 2), v1 = chv(t0 - 1), S = 0.f;
                for (int k = 1; k < w; ++k) S += uv(t0 - k);
                for (int t = t0; t < t0 + CH; ++t) {
                    const float v0 = chv(t), cv = w0 * v2 + w1 * v1 + w2 * v0, bb = pr[(size_t)t * DIN + c];
                    A2[((size_t)b * Lq + t) * DM + c] = (bf16)f2bf(bb * cv);
                    if (t >= Lq - 2) g.new_conv[((size_t)b * 2 + (t - (Lq - 2))) * DM + c] = v0;
                    v2 = v1; v1 = v0;
                    const float u = uv(t); S += u;
                    const int pos = g.pos0 + t + 1; const float cnt = (float)(pos < w ? pos : w);
                    Dd[((size_t)b * Lq + t) * DM + c] = (bf16)f2bf(S / cnt - u);
                    S -= uv(t - w + 1);
                }
                if (t0 + CH == Lq) for (int j = 0; j < 15; ++j) g.new_pool[((size_t)b * 15 + j) * DM + c] = uv(Lq - 15 + j);
            }
        }
        xcd_barrier(bar);
        sgemm(A2, DM, Wt_a, DM, R, DM, DM, gw, NGW, lane, EpiStoreF32{YA, DM, 0});
        for (int gi = 0; gi < 4; ++gi) sgemm(Dd + 256 * gi, DM, Wt_p + (size_t)gi * 256 * 256, 256, R, 256, 256, gw, NGW, lane, EpiStoreF32{YP, DM, 256 * gi});
        xcd_barrier(bar);
        for (size_t e = (size_t)vcu * NTHR + tid; e < (size_t)R * DM; e += (size_t)G * NTHR) {
            const size_t r = e / DM; const int c = (int)(e % DM);
            const float ga = PROJ[r * DIN + 4 * DM + c], gp = PROJ[r * DIN + 5 * DM + c];
            MG[e] = (bf16)f2bf(sigmoidf_(ga) * YA[e] + sigmoidf_(gp) * (YP[e] * pool_scale[c]));
        }
        xcd_barrier(bar);
        sgemm(MG, DM, Wt_o, DM, R, DM, DM, gw, NGW, lane, EpiStoreF32{YA, DM, 0});
        xcd_barrier(bar);
        for (int r = gw; r < R; r += NGW) {
            const f32x4* mr = (const f32x4*)(YA + (size_t)r * DM) + lane; const f32x4* xr = (const f32x4*)(g.x + (size_t)r * DM) + lane; f32x4 v[4]; float s = 0.f;
#pragma unroll
            for (int j = 0; j < 4; ++j) { v[j] = mr[64 * j]; s += (v[j].x * v[j].x + v[j].y * v[j].y) + (v[j].z * v[j].z + v[j].w * v[j].w); }
            const float rs = rsqrtf(wave_sum(s) * (1.f / DM) + EPS); float s2 = 0.f;
#pragma unroll
            for (int j = 0; j < 4; ++j) { const f32x4 gg = ((const f32x4*)g_post_mix)[lane + 64 * j]; const f32x4 xx = xr[64 * j];
                v[j].x = xx.x + v[j].x * rs * gg.x; v[j].y = xx.y + v[j].y * rs * gg.y; v[j].z = xx.z + v[j].z * rs * gg.z; v[j].w = xx.w + v[j].w * rs * gg.w;
                s2 += (v[j].x * v[j].x + v[j].y * v[j].y) + (v[j].z * v[j].z + v[j].w * v[j].w);
                ((f32x4*)(X1 + (size_t)r * DM))[lane + 64 * j] = v[j]; }
            const float rs2 = rsqrtf(wave_sum(s2) * (1.f / DM) + EPS);
            v2u* o8 = (v2u*)(XN + (size_t)r * DM) + lane;
#pragma unroll
            for (int j = 0; j < 4; ++j) { const f32x4 gg = ((const f32x4*)g_pre_ffn)[lane + 64 * j]; v2u o; o.x = pk2(v[j].x * rs2 * gg.x, v[j].y * rs2 * gg.y); o.y = pk2(v[j].z * rs2 * gg.z, v[j].w * rs2 * gg.w); o8[64 * j] = o; }
        }
        xcd_barrier(bar);
        sgemm(XN, DM, Wt_up, DM, R, 2 * DFF, DM, gw, NGW, lane, EpiStoreF32{PROJ, 2 * DFF, 0});
        xcd_barrier(bar);
        {
            const int CH = Lq < 32 ? Lq : 32, nch = Lq / CH, ncb = (DFF + NTHR - 1) / NTHR, nitems = g.nseq * nch * ncb;
            for (int it = vcu; it < nitems; it += G) {
                const int cb = it % ncb, chk = (it / ncb) % nch, b = (it / ncb) / nch, c = cb * NTHR + tid, t0 = chk * CH;
                if (c < DFF) {
                    const float w0 = ffn_conv_w[c], w1 = ffn_conv_w[DFF + c], w2 = ffn_conv_w[2 * DFF + c];
                    const float* pr = PROJ + (size_t)b * Lq * (2 * DFF);
                    auto av = [&](int t) -> float { if (t >= 0) return pr[(size_t)t * (2 * DFF) + c]; return g.st_ffn ? g.st_ffn[((size_t)b * 2 + (2 + t)) * DFF + c] : 0.f; };
                    float v2 = av(t0 - 2), v1 = av(t0 - 1);
                    for (int t = t0; t < t0 + CH; ++t) {
                        const float v0 = av(t), cv = w0 * v2 + w1 * v1 + w2 * v0, gg = pr[(size_t)t * (2 * DFF) + DFF + c];
                        HM[((size_t)b * Lq + t) * DFF + c] = (bf16)f2bf(gelu_tanh(cv) * gg);
                        if (t >= Lq - 2) g.new_ffn[((size_t)b * 2 + (t - (Lq - 2))) * DFF + c] = v0;
                        v2 = v1; v1 = v0;
                    }
                }
            }
        }
        xcd_barrier(bar);
        sgemm(HM, DFF, Wt_dn, DFF, R, DM, DFF, gw, NGW, lane, EpiStoreF32{YA, DM, 0});
        xcd_barrier(bar);
        for (int r = gw; r < R; r += NGW) {
            const f32x4* fr = (const f32x4*)(YA + (size_t)r * DM) + lane; f32x4* xr = (f32x4*)(X1 + (size_t)r * DM) + lane; f32x4 v[4]; float s = 0.f;
#pragma unroll
            for (int j = 0; j < 4; ++j) { v[j] = fr[64 * j]; s += (v[j].x * v[j].x + v[j].y * v[j].y) + (v[j].z * v[j].z + v[j].w * v[j].w); }
            const float rs = rsqrtf(wave_sum(s) * (1.f / DM) + EPS);
            v2u* o8 = (v2u*)(XN + (size_t)r * DM) + lane;
#pragma unroll
            for (int j = 0; j < 4; ++j) { const f32x4 gg = ((const f32x4*)g_post_ffn)[lane + 64 * j]; f32x4 xx = xr[64 * j];
                xx.x += v[j].x * rs * gg.x; xx.y += v[j].y * rs * gg.y; xx.z += v[j].z * rs * gg.z; xx.w += v[j].w * rs * gg.w; xr[64 * j] = xx;
                v2u o; o.x = pk2(xx.x, xx.y); o.y = pk2(xx.z, xx.w); o8[64 * j] = o; }
            const f32x4 pv = ((const f32x4*)(g.p + (size_t)r * PLE))[lane]; v2u o; o.x = pk2(pv.x, pv.y); o.y = pk2(pv.z, pv.w); ((v2u*)(PB + (size_t)r * PLE))[lane] = o;
        }
        xcd_barrier(bar);
        sgemm(XN, DM, Wt_g, DM, R, DM, DM, gw, NGW, lane, EpiStoreF32{YA, DM, 0});
        sgemm(PB, PLE, Wt_ple, PLE, R, DM, PLE, gw, NGW, lane, EpiStoreF32{YP, DM, 0});
        xcd_barrier(bar);
        for (size_t e = (size_t)vcu * NTHR + tid; e < (size_t)R * DM; e += (size_t)G * NTHR) g.y[e] = X1[e] + sigmoidf_(YA[e]) * YP[e];
        xcd_barrier(bar);
    }
}

extern "C" void kernel_launch(void* const* d_in, const int* in_sizes, int n_in, void* d_out, int out_size, void* d_ws, size_t ws_size, hipStream_t stream) {
    static int grid = 0;
    if (grid == 0) {
        if (n_in != 22 || (size_t)out_size != O_END || ws_size < WS_END) { fprintf(stderr, "kernel_launch: unexpected shapes n_in %d out %d ws %zu\n", n_in, out_size, ws_size); grid = -1; return; }
        int dev = 0, cus = 0;
        if (hipGetDevice(&dev) != hipSuccess || hipDeviceGetAttribute(&cus, hipDeviceAttributeMultiprocessorCount, dev) != hipSuccess) { grid = -1; return; }
        if (hipFuncSetAttribute((const void*)fwd_kernel, hipFuncAttributeMaxDynamicSharedMemorySize, LDS_BYTES) != hipSuccess) { fprintf(stderr, "kernel_launch: hipFuncSetAttribute failed\n"); grid = -1; return; }
        grid = cus;
    }
    if (grid < 0) return;
    (void)hipMemsetAsync((char*)d_ws + WS_CTL, 0, CTL_ZERO_BYTES, stream);
    Args a{};
    for (int i = 0; i < 22; ++i) a.in[i] = (const float*)d_in[i];
    a.out = (float*)d_out; a.ws = (unsigned char*)d_ws;
    hipLaunchKernelGGL(fwd_kernel, dim3(grid), dim3(NTHR), LDS_BYTES, stream, a);
}
```
